# Optimizing an MI355X kernel written in HIP

```python
import math
import jax
import jax.numpy as jnp
from jax import lax
import numpy as np

D_MODEL = 1024
BATCH = 2
SEQ = 8192
DEPTH = 2

N_MIXERS = 2
Q_BLOCK = 128
NORM_EPS = 1e-6
FOX_HEADS = 16
FOX_HEAD_DIM = D_MODEL // FOX_HEADS
FOX_WIDTH = FOX_HEADS * FOX_HEAD_DIM
MLA_HEADS = 16
MLA_NOPE_DIM = 64
MLA_ROPE_DIM = 32
MLA_V_DIM = 64
MLA_Q_RANK = 384
MLA_KV_RANK = 256
ROPE_BASE = 10000.0
D_FF = 2816
CONV_WIDTH = 3
N_FOX_LAYERS = (DEPTH + 1) // 2
N_MLA_LAYERS = DEPTH // 2

kernel_name = 'hybrid_fox_mla_convffn_adaln'


def rms_norm(x):
    xf = x.astype(jnp.float32)
    y = xf * lax.rsqrt(jnp.mean(xf * xf, axis=-1, keepdims=True) + NORM_EPS)
    return y.astype(x.dtype)


def ada_modulation(c, w, b):
    mod = jax.nn.silu(c) @ w + b
    shift, scale, gate = jnp.split(mod[:, None, :], 3, axis=-1)
    return shift, scale, gate


def causal_mask(start, seq):
    q_pos = start + jnp.arange(Q_BLOCK)
    return q_pos[:, None] >= jnp.arange(seq)[None, :]


def masked_softmax(s, mask):
    s = jnp.where(mask, s.astype(jnp.float32), -jnp.inf)
    return jax.nn.softmax(s, axis=-1)


def causal_block_sweep(block_fn, batch, seq):
    starts = jnp.arange(seq // Q_BLOCK, dtype=jnp.int32) * Q_BLOCK
    out = lax.map(block_fn, starts)
    return jnp.moveaxis(out, 0, 1).reshape(batch, seq, -1)


def forgetting_attention(h, w_in, b_f, w_o):
    B, S, _ = h.shape
    proj = h @ w_in
    q, k, v, f_logit = jnp.split(proj, [FOX_WIDTH, 2 * FOX_WIDTH, 3 * FOX_WIDTH], axis=-1)
    q = q.reshape(B, S, FOX_HEADS, FOX_HEAD_DIM)
    k = k.reshape(B, S, FOX_HEADS, FOX_HEAD_DIM)
    v = v.reshape(B, S, FOX_HEADS, FOX_HEAD_DIM)
    log_f = jax.nn.log_sigmoid((f_logit + b_f).astype(jnp.float32))
    cum = jnp.cumsum(log_f, axis=1).transpose(0, 2, 1)
    scale = FOX_HEAD_DIM ** -0.5

    def block(start):
        qb = lax.dynamic_slice_in_dim(q, start, Q_BLOCK, axis=1)
        cq = lax.dynamic_slice_in_dim(cum, start, Q_BLOCK, axis=2)
        s = jnp.einsum('bqhd,bkhd->bhqk', qb, k).astype(jnp.float32) * scale
        s = s + (cq[..., :, None] - cum[..., None, :])
        p = masked_softmax(s, causal_mask(start, S))
        return jnp.einsum('bhqk,bkhd->bqhd', p.astype(v.dtype), v)

    o = causal_block_sweep(block, B, S)
    return o @ w_o


def apply_rope(x, cos, sin):
    half = x.shape[-1] // 2
    x1, x2 = x[..., :half], x[..., half:]
    return jnp.concatenate([x1 * cos - x2 * sin, x2 * cos + x1 * sin], axis=-1)


def latent_attention(h, w_a, g_q, g_kv, w_uq, w_ukv, w_o):
    B, S, _ = h.shape
    a = h @ w_a
    c_q, c_kv, k_rope = jnp.split(a, [MLA_Q_RANK, MLA_Q_RANK + MLA_KV_RANK], axis=-1)
    c_q = rms_norm(c_q) * g_q
    c_kv = rms_norm(c_kv) * g_kv
    q = (c_q @ w_uq).reshape(B, S, MLA_HEADS, MLA_NOPE_DIM + MLA_ROPE_DIM)
    q_nope, q_rope = q[..., :MLA_NOPE_DIM], q[..., MLA_NOPE_DIM:]
    kv = (c_kv @ w_ukv).reshape(B, S, MLA_HEADS, MLA_NOPE_DIM + MLA_V_DIM)
    k_nope, v = kv[..., :MLA_NOPE_DIM], kv[..., MLA_NOPE_DIM:]

    pos = jnp.arange(S, dtype=jnp.float32)
    inv_freq = ROPE_BASE ** (-jnp.arange(0, MLA_ROPE_DIM, 2, dtype=jnp.float32) / MLA_ROPE_DIM)
    ang = pos[:, None] * inv_freq[None, :]
    cos = jnp.cos(ang).astype(h.dtype)
    sin = jnp.sin(ang).astype(h.dtype)
    q_rope = apply_rope(q_rope, cos[:, None, :], sin[:, None, :])
    k_rope = apply_rope(k_rope, cos, sin)
    scale = (MLA_NOPE_DIM + MLA_ROPE_DIM) ** -0.5

    def block(start):
        qn = lax.dynamic_slice_in_dim(q_nope, start, Q_BLOCK, axis=1)
        qr = lax.dynamic_slice_in_dim(q_rope, start, Q_BLOCK, axis=1)
        s = jnp.einsum('bqhd,bkhd->bhqk', qn, k_nope) + jnp.einsum('bqhr,bkr->bhqk', qr, k_rope)
        p = masked_softmax(s.astype(jnp.float32) * scale, causal_mask(start, S))
        return jnp.einsum('bhqk,bkhd->bqhd', p.astype(v.dtype), v)

    o = causal_block_sweep(block, B, S)
    return o @ w_o


def conv_gated_mlp(h, w_in, conv_w, conv_b, w_out):
    S = h.shape[1]
    u = h @ w_in
    u_pad = jnp.pad(u, ((0, 0), (CONV_WIDTH - 1, 0), (0, 0)))
    y = conv_b
    for j in range(CONV_WIDTH):
        y = y + conv_w[j] * u_pad[:, j:j + S, :]
    gate, val = jnp.split(y, 2, axis=-1)
    return (jax.nn.silu(gate) * val) @ w_out


def setup_inputs(seed: int = 0) -> dict:
    key = jax.random.key(seed)
    ks = jax.random.split(key, 20)
    D = D_MODEL
    nrm = jax.random.normal
    f32 = jnp.float32
    x = nrm(ks[0], (BATCH, SEQ, D), f32)
    c = nrm(ks[1], (BATCH, D), f32)
    ada_w = nrm(ks[2], (DEPTH, 2, D, 3 * D), f32) * D ** -0.5
    ada_b = 0.02 * nrm(ks[3], (DEPTH, 2, 3 * D), f32)
    fox_w_in = nrm(ks[4], (N_FOX_LAYERS, D, 3 * FOX_WIDTH + FOX_HEADS), f32) * D ** -0.5
    fox_w_in = fox_w_in.at[..., 3 * FOX_WIDTH:].multiply(0.1)
    fox_b_f = jnp.linspace(2.0, 6.0, FOX_HEADS, dtype=f32)[None, :] + 0.1 * nrm(ks[5], (N_FOX_LAYERS, FOX_HEADS), f32)
    fox_w_o = nrm(ks[6], (N_FOX_LAYERS, FOX_WIDTH, D), f32) * FOX_WIDTH ** -0.5
    mla_w_a = nrm(ks[7], (N_MLA_LAYERS, D, MLA_Q_RANK + MLA_KV_RANK + MLA_ROPE_DIM), f32) * D ** -0.5
    mla_g_q = 1.0 + 0.02 * nrm(ks[8], (N_MLA_LAYERS, MLA_Q_RANK), f32)
    mla_g_kv = 1.0 + 0.02 * nrm(ks[9], (N_MLA_LAYERS, MLA_KV_RANK), f32)
    mla_w_uq = nrm(ks[10], (N_MLA_LAYERS, MLA_Q_RANK, MLA_HEADS * (MLA_NOPE_DIM + MLA_ROPE_DIM)), f32) * MLA_Q_RANK ** -0.5
    mla_w_ukv = nrm(ks[11], (N_MLA_LAYERS, MLA_KV_RANK, MLA_HEADS * (MLA_NOPE_DIM + MLA_V_DIM)), f32) * MLA_KV_RANK ** -0.5
    mla_w_o = nrm(ks[12], (N_MLA_LAYERS, MLA_HEADS * MLA_V_DIM, D), f32) * (MLA_HEADS * MLA_V_DIM) ** -0.5
    ffn_w_in = nrm(ks[13], (DEPTH, D, 2 * D_FF), f32) * D ** -0.5
    ffn_conv_w = nrm(ks[14], (DEPTH, CONV_WIDTH, 2 * D_FF), f32) * CONV_WIDTH ** -0.5
    ffn_conv_b = 0.02 * nrm(ks[15], (DEPTH, 2 * D_FF), f32)
    ffn_w_out = nrm(ks[16], (DEPTH, D_FF, D), f32) * D_FF ** -0.5
    final_g = 1.0 + 0.02 * nrm(ks[17], (D,), f32)
    return {'x': x, 'c': c, 'ada_w': ada_w, 'ada_b': ada_b,
            'fox_w_in': fox_w_in, 'fox_b_f': fox_b_f, 'fox_w_o': fox_w_o,
            'mla_w_a': mla_w_a, 'mla_g_q': mla_g_q, 'mla_g_kv': mla_g_kv,
            'mla_w_uq': mla_w_uq, 'mla_w_ukv': mla_w_ukv, 'mla_w_o': mla_w_o,
            'ffn_w_in': ffn_w_in, 'ffn_conv_w': ffn_conv_w, 'ffn_conv_b': ffn_conv_b,
            'ffn_w_out': ffn_w_out, 'final_g': final_g}


def reference(x, c, ada_w, ada_b, fox_w_in, fox_b_f, fox_w_o, mla_w_a, mla_g_q, mla_g_kv,
              mla_w_uq, mla_w_ukv, mla_w_o, ffn_w_in, ffn_conv_w, ffn_conv_b, ffn_w_out, final_g):
    for i in range(DEPTH):
        j = i // N_MIXERS
        shift, scale, gate = ada_modulation(c, ada_w[i, 0], ada_b[i, 0])
        h = rms_norm(x) * (1.0 + scale) + shift
        if i % N_MIXERS == 0:
            y = forgetting_attention(h, fox_w_in[j], fox_b_f[j], fox_w_o[j])
        else:
            y = latent_attention(h, mla_w_a[j], mla_g_q[j], mla_g_kv[j],
                                 mla_w_uq[j], mla_w_ukv[j], mla_w_o[j])
        x = x + gate * y
        shift, scale, gate = ada_modulation(c, ada_w[i, 1], ada_b[i, 1])
        h = rms_norm(x) * (1.0 + scale) + shift
        x = x + gate * conv_gated_mlp(h, ffn_w_in[i], ffn_conv_w[i], ffn_conv_b[i], ffn_w_out[i])
    return rms_norm(x) * final_g
```

```cpp
#include <hip/hip_runtime.h>
#include <stdint.h>
#include <math.h>

typedef unsigned short bf16_t;
typedef short bf16x8 __attribute__((ext_vector_type(8)));
typedef float f32x4 __attribute__((ext_vector_type(4)));

constexpr int BATCH = 2, SEQ = 8192, D = 1024, M = BATCH * SEQ, H = 16, DFF = 2816;
constexpr float LOG2E = 1.4426950408889634f;
constexpr float EPS = 1e-6f;

__device__ __forceinline__ unsigned short f2bf(float f) { unsigned u = __float_as_uint(f); return (unsigned short)((u + 0x7fffu + ((u >> 16) & 1u)) >> 16); }
__device__ __forceinline__ float bf2f(unsigned short h) { return __uint_as_float((unsigned)h << 16); }
__device__ __forceinline__ float wave_sum(float v) {
#pragma unroll
    for (int o = 1; o < 64; o <<= 1) v += __shfl_xor(v, o);
    return v;
}

__global__ void k_ada(const float* c, const float* ada_w, const float* ada_b, float* mod) {
    const int idx = blockIdx.x * blockDim.x + threadIdx.x;
    if (idx >= 4 * 3072) return;
    const int ij = idx / 3072, n = idx % 3072;
    const float* W = ada_w + (size_t)ij * 1024 * 3072;
    float a0 = 0.f, a1 = 0.f;
    for (int k = 0; k < 1024; ++k) {
        const float w = W[(size_t)k * 3072 + n];
        const float c0 = c[k], c1 = c[1024 + k];
        a0 += (c0 / (1.f + expf(-c0))) * w; a1 += (c1 / (1.f + expf(-c1))) * w;
    }
    const float bb = ada_b[ij * 3072 + n];
    mod[(ij * 2 + 0) * 3072 + n] = a0 + bb; mod[(ij * 2 + 1) * 3072 + n] = a1 + bb;
}

__global__ void k_norm_mod(const float* x, const float* mod  , bf16_t* XN) {
    const int lane = threadIdx.x & 63, wave = (blockIdx.x * blockDim.x + threadIdx.x) >> 6, nw = (gridDim.x * blockDim.x) >> 6;
    for (int m = wave; m < M; m += nw) {
        const int b = m / SEQ; const float* xr = x + (size_t)m * D; float v[16]; float s = 0.f;
#pragma unroll
        for (int j = 0; j < 4; ++j) { const f32x4 t = *(const f32x4*)(xr + 256 * j + 4 * lane); v[4 * j] = t[0]; v[4 * j + 1] = t[1]; v[4 * j + 2] = t[2]; v[4 * j + 3] = t[3]; s += t[0] * t[0] + t[1] * t[1] + t[2] * t[2] + t[3] * t[3]; }
        const float r = rsqrtf(wave_sum(s) * (1.f / D) + EPS);
        const float* sh = mod + b * 3072; const float* sc = sh + 1024;
#pragma unroll
        for (int j = 0; j < 4; ++j)
#pragma unroll
            for (int e = 0; e < 4; ++e) { const int col = 256 * j + 4 * lane + e; XN[(size_t)m * D + col] = f2bf(v[4 * j + e] * r * (1.f + sc[col]) + sh[col]); }
    }
}

__global__ void k_final(float* x, const float* g) {
    const int lane = threadIdx.x & 63, wave = (blockIdx.x * blockDim.x + threadIdx.x) >> 6, nw = (gridDim.x * blockDim.x) >> 6;
    for (int m = wave; m < M; m += nw) {
        float* xr = x + (size_t)m * D; f32x4 t[4]; float s = 0.f;
#pragma unroll
        for (int j = 0; j < 4; ++j) { t[j] = *(const f32x4*)(xr + 256 * j + 4 * lane); s += t[j][0] * t[j][0] + t[j][1] * t[j][1] + t[j][2] * t[j][2] + t[j][3] * t[j][3]; }
        const float r = rsqrtf(wave_sum(s) * (1.f / D) + EPS);
#pragma unroll
        for (int j = 0; j < 4; ++j) { const f32x4 gg = *(const f32x4*)(g + 256 * j + 4 * lane); *(f32x4*)(xr + 256 * j + 4 * lane) = t[j] * r * gg; }
    }
}

template <class Epi>
__global__ __launch_bounds__(256) void k_gemm(const bf16_t* A, int lda, const float* W, int ldw, int N, int K, Epi epi) {
    const int lane = threadIdx.x & 63, fr = lane & 15, fq = lane >> 4;
    const int wave = (blockIdx.x * 256 + threadIdx.x) >> 6, nw = gridDim.x * 4;
    const int ntn = (N + 31) / 32, ntiles = (M / 64) * ntn;
    for (int t = wave; t < ntiles; t += nw) {
        const int tn = t % ntn, tm = t / ntn, r0 = tm * 64, c0 = tn * 32;
        f32x4 acc[4][2];
#pragma unroll
        for (int m = 0; m < 4; ++m) { acc[m][0] = (f32x4){0.f, 0.f, 0.f, 0.f}; acc[m][1] = (f32x4){0.f, 0.f, 0.f, 0.f}; }
        for (int k0 = 0; k0 < K; k0 += 32) {
            bf16x8 a[4], b[2];
#pragma unroll
            for (int m = 0; m < 4; ++m) a[m] = *(const bf16x8*)(A + (size_t)(r0 + 16 * m + fr) * lda + k0 + 8 * fq);
#pragma unroll
            for (int n = 0; n < 2; ++n) { const int col = c0 + 16 * n + fr;
#pragma unroll
                for (int j = 0; j < 8; ++j) b[n][j] = (col < N) ? (short)f2bf(W[(size_t)(k0 + 8 * fq + j) * ldw + col]) : (short)0; }
#pragma unroll
            for (int m = 0; m < 4; ++m)
#pragma unroll
                for (int n = 0; n < 2; ++n) acc[m][n] = __builtin_amdgcn_mfma_f32_16x16x32_bf16(a[m], b[n], acc[m][n], 0, 0, 0);
        }
#pragma unroll
        for (int m = 0; m < 4; ++m)
#pragma unroll
            for (int j = 0; j < 4; ++j) epi(r0 + 16 * m + 4 * fq + j, c0 + fr, acc[m][0][j], acc[m][1][j], (c0 + 16 + fr) < N);
    }
}

struct EpiFoxIn {
    bf16_t *Q, *Kb, *V; float* lf; const float* b_f; float c2; int pad;
    __device__ void one(int row, int col, float v) const {
        if (col < 1024) Q[(size_t)row * D + col] = f2bf(v * c2);
        else if (col < 2048) Kb[(size_t)row * D + col - 1024] = f2bf(v);
        else if (col < 3072) V[(size_t)row * D + col - 2048] = f2bf(v);
        else { const int h = col - 3072; const float z = v + b_f[h]; const float ls = fminf(z, 0.f) - log1pf(expf(-fabsf(z))); lf[((size_t)(row / SEQ) * H + h) * SEQ + (row % SEQ)] = ls; }
    }
    __device__ void operator()(int row, int col, float v0, float v1, bool has1) const { one(row, col, v0); if (has1) one(row, col + 16, v1); }
};
struct EpiResid {
    const float* base; float* out; const float* gate  ;
    __device__ void one(int row, int col, float v) const { const int b = row / SEQ; out[(size_t)row * D + col] = base[(size_t)row * D + col] + gate[b * 3072 + 2048 + col] * v; }
    __device__ void operator()(int row, int col, float v0, float v1, bool has1) const { one(row, col, v0); if (has1) one(row, col + 16, v1); }
};
struct EpiMlaA {
    float* a; bf16_t* Kr; const float* rope  ;
    __device__ void operator()(int row, int col, float v0, float v1, bool has1) const {
        if (col < 640) { a[(size_t)row * 640 + col] = v0; if (has1 && col + 16 < 640) a[(size_t)row * 640 + col + 16] = v1; }
        else { const int i = col - 640, s = row % SEQ; const float cs = rope[(s * 16 + i) * 2], sn = rope[(s * 16 + i) * 2 + 1];
               Kr[(size_t)row * 32 + i] = f2bf(v0 * cs - v1 * sn); Kr[(size_t)row * 32 + 16 + i] = f2bf(v1 * cs + v0 * sn); }
    }
};
struct EpiMlaQ {
    bf16_t *Q, *Qr; const float* rope; float c2; int pad;
    __device__ void operator()(int row, int col, float v0, float v1, bool has1) const {
        const int h = col / 96, d = col % 96;
        if (d < 64) { Q[(size_t)row * D + h * 64 + d] = f2bf(v0 * c2); const int c1 = col + 16, h1 = c1 / 96, d1 = c1 % 96;   Q[(size_t)row * D + h1 * 64 + d1] = f2bf(v1 * c2); }
        else { const int i = d - 64, s = row % SEQ; const float cs = rope[(s * 16 + i) * 2], sn = rope[(s * 16 + i) * 2 + 1];
               Qr[(size_t)row * 512 + h * 32 + i] = f2bf((v0 * cs - v1 * sn) * c2); Qr[(size_t)row * 512 + h * 32 + 16 + i] = f2bf((v1 * cs + v0 * sn) * c2); }
    }
};
struct EpiMlaKV {
    bf16_t *Kb, *V;
    __device__ void one(int row, int col, float v) const { const int h = col / 128, d = col % 128; if (d < 64) Kb[(size_t)row * D + h * 64 + d] = f2bf(v); else V[(size_t)row * D + h * 64 + d - 64] = f2bf(v); }
    __device__ void operator()(int row, int col, float v0, float v1, bool has1) const { one(row, col, v0); if (has1) one(row, col + 16, v1); }
};

__global__ __launch_bounds__(256) void k_scan(const float* lf, float* cumq) {
    __shared__ double part[256];
    const int bh = blockIdx.x, tid = threadIdx.x; const float* src = lf + (size_t)bh * SEQ + tid * 32; float v[32]; double s = 0.0;
#pragma unroll
    for (int i = 0; i < 32; ++i) { v[i] = src[i]; s += (double)v[i]; }
    part[tid] = s; __syncthreads();
    if (tid == 0) { double run = 0.0; for (int i = 0; i < 256; ++i) { const double t = part[i]; part[i] = run; run += t; } }
    __syncthreads();
    double run = part[tid]; float* dst = cumq + (size_t)bh * SEQ + tid * 32;
#pragma unroll
    for (int i = 0; i < 32; ++i) { run += (double)v[i]; dst[i] = (float)(run * 1.4426950408889634); }
}

__global__ void k_rope_table(float* rope) {
    const int idx = blockIdx.x * blockDim.x + threadIdx.x; if (idx >= SEQ * 16) return;
    const int s = idx / 16, i = idx % 16;
    const float inv = powf(10000.f, -(float)(2 * i) / 32.f); const float ang = (float)s * inv;
    rope[idx * 2] = (float)cos((double)ang); rope[idx * 2 + 1] = (float)sin((double)ang);
}

__global__ void k_mla_prep(const float* a, const float* g_q, const float* g_kv, bf16_t* CQ, bf16_t* CKV) {
    const int lane = threadIdx.x & 63, wave = (blockIdx.x * blockDim.x + threadIdx.x) >> 6, nw = (gridDim.x * blockDim.x) >> 6;
    for (int m = wave; m < M; m += nw) {
        const float* ar = a + (size_t)m * 640; float q[6], kv[4]; float sq = 0.f, sk = 0.f;
#pragma unroll
        for (int j = 0; j < 6; ++j) { q[j] = ar[64 * j + lane]; sq += q[j] * q[j]; }
#pragma unroll
        for (int j = 0; j < 4; ++j) { kv[j] = ar[384 + 64 * j + lane]; sk += kv[j] * kv[j]; }
        const float rq = rsqrtf(wave_sum(sq) * (1.f / 384.f) + EPS), rk = rsqrtf(wave_sum(sk) * (1.f / 256.f) + EPS);
#pragma unroll
        for (int j = 0; j < 6; ++j) CQ[(size_t)m * 384 + 64 * j + lane] = f2bf(q[j] * rq * g_q[64 * j + lane]);
#pragma unroll
        for (int j = 0; j < 4; ++j) CKV[(size_t)m * 256 + 64 * j + lane] = f2bf(kv[j] * rk * g_kv[64 * j + lane]);
    }
}

template <int DX  , bool FOX>
__global__ __launch_bounds__(256) void k_attn(const bf16_t* Q, const bf16_t* Qx, const bf16_t* Kb, const bf16_t* Kx, const bf16_t* V, const float* cumq, bf16_t* O) {
    constexpr int DQK = 64 + DX;
    __shared__ float Ks[64][DQK]; __shared__ float Vs[64][64]; __shared__ float cks[64];
    const int tid = threadIdx.x; const int qb = 31 - (blockIdx.x % 32), bh = blockIdx.x / 32, b = bh / H, h = bh % H;
    const int s_q = qb * 256 + tid; const size_t row = (size_t)b * SEQ + s_q;
    float q[DQK], o[64];
#pragma unroll
    for (int d = 0; d < 64; ++d) { q[d] = bf2f(Q[row * D + h * 64 + d]); o[d] = 0.f; }
#pragma unroll
    for (int d = 0; d < DX; ++d) q[64 + d] = bf2f(Qx[row * 512 + h * 32 + d]);
    const float cq = FOX ? cumq[(size_t)bh * SEQ + s_q] : 0.f;
    float mx = -INFINITY, l = 0.f;
    const int ntile = (qb * 256 + 256) / 64;
    for (int t = 0; t < ntile; ++t) {
        __syncthreads();
        for (int e = tid; e < 64 * 64; e += 256) { const int kk = e / 64, d = e % 64; const size_t kr = (size_t)b * SEQ + t * 64 + kk; Ks[kk][d] = bf2f(Kb[kr * D + h * 64 + d]); Vs[kk][d] = bf2f(V[kr * D + h * 64 + d]); }
        if (DX) for (int e = tid; e < 64 * DX; e += 256) { const int kk = e / (DX ? DX : 1), d = e % (DX ? DX : 1); const size_t kr = (size_t)b * SEQ + t * 64 + kk; Ks[kk][64 + d] = bf2f(Kx[kr * 32 + d]); }
        if (FOX && tid < 64) cks[tid] = cumq[(size_t)bh * SEQ + t * 64 + tid];
        __syncthreads();
        for (int kk = 0; kk < 64; ++kk) {
            const int key = t * 64 + kk; if (key > s_q) break;
            float s = 0.f;
#pragma unroll
            for (int d = 0; d < DQK; ++d) s += q[d] * Ks[kk][d];
            if (FOX) s += cq - cks[kk];
            if (s > mx) { const float f = exp2f(mx - s); l *= f;
#pragma unroll
                for (int d = 0; d < 64; ++d) o[d] *= f;
                mx = s; }
            const float p = exp2f(s - mx); l += p;
#pragma unroll
            for (int d = 0; d < 64; ++d) o[d] += p * Vs[kk][d];
        }
    }
    const float il = 1.f / l;
#pragma unroll
    for (int d = 0; d < 64; ++d) O[row * D + h * 64 + d] = f2bf(o[d] * il);
}

__global__ __launch_bounds__(256) void k_ffn_up(const bf16_t* XN, const float* Win  , const float* cw  , const float* cb  , bf16_t* G) {
    const int lane = threadIdx.x & 63, fr = lane & 15, fq = lane >> 4;
    const int wave = (blockIdx.x * 256 + threadIdx.x) >> 6, nw = gridDim.x * 4;
    constexpr int NTN = DFF / 16, NT = (M / 64) * NTN;
    for (int t = wave; t < NT; t += nw) {
        const int tn = t % NTN, tm = t / NTN, r0 = tm * 64, c0 = tn * 16;
        f32x4 acc[3][2][4];
#pragma unroll
        for (int a = 0; a < 3; ++a)
#pragma unroll
            for (int g = 0; g < 2; ++g)
#pragma unroll
                for (int m = 0; m < 4; ++m) acc[a][g][m] = (f32x4){0.f, 0.f, 0.f, 0.f};
        for (int k0 = 0; k0 < 1024; k0 += 32) {
            bf16x8 bfr[2];
#pragma unroll
            for (int g = 0; g < 2; ++g)
#pragma unroll
                for (int j = 0; j < 8; ++j) bfr[g][j] = (short)f2bf(Win[(size_t)(k0 + 8 * fq + j) * (2 * DFF) + g * DFF + c0 + fr]);
#pragma unroll
            for (int tap = 0; tap < 3; ++tap)
#pragma unroll
                for (int m = 0; m < 4; ++m) {
                    const int row = r0 + 16 * m + fr, sh = 2 - tap; bf16x8 a = (bf16x8){0, 0, 0, 0, 0, 0, 0, 0};
                    if ((row % SEQ) - sh >= 0) a = *(const bf16x8*)(XN + (size_t)(row - sh) * D + k0 + 8 * fq);
                    acc[tap][0][m] = __builtin_amdgcn_mfma_f32_16x16x32_bf16(a, bfr[0], acc[tap][0][m], 0, 0, 0);
                    acc[tap][1][m] = __builtin_amdgcn_mfma_f32_16x16x32_bf16(a, bfr[1], acc[tap][1][m], 0, 0, 0);
                }
        }
        const int ch = c0 + fr;
        const float wg0 = cw[ch], wg1 = cw[2 * DFF + ch], wg2 = cw[4 * DFF + ch], bg = cb[ch];
        const float wv0 = cw[DFF + ch], wv1 = cw[3 * DFF + ch], wv2 = cw[5 * DFF + ch], bv = cb[DFF + ch];
#pragma unroll
        for (int m = 0; m < 4; ++m)
#pragma unroll
            for (int j = 0; j < 4; ++j) {
                const int row = r0 + 16 * m + 4 * fq + j;
                const float yg = bg + wg0 * acc[0][0][m][j] + wg1 * acc[1][0][m][j] + wg2 * acc[2][0][m][j];
                const float yv = bv + wv0 * acc[0][1][m][j] + wv1 * acc[1][1][m][j] + wv2 * acc[2][1][m][j];
                G[(size_t)row * DFF + ch] = f2bf(yg / (1.f + expf(-yg)) * yv);
            }
    }
}

constexpr size_t MiB = 1u << 20;
extern "C" void kernel_launch(void* const* d_in, const int* in_sizes, int n_in, void* d_out, int out_size, void* d_ws, size_t ws_size, hipStream_t stream) {
    const float* x = (const float*)d_in[0]; const float* c = (const float*)d_in[1]; const float* ada_w = (const float*)d_in[2]; const float* ada_b = (const float*)d_in[3];
    const float* fox_w_in = (const float*)d_in[4]; const float* fox_b_f = (const float*)d_in[5]; const float* fox_w_o = (const float*)d_in[6];
    const float* mla_w_a = (const float*)d_in[7]; const float* mla_g_q = (const float*)d_in[8]; const float* mla_g_kv = (const float*)d_in[9];
    const float* mla_w_uq = (const float*)d_in[10]; const float* mla_w_ukv = (const float*)d_in[11]; const float* mla_w_o = (const float*)d_in[12];
    const float* ffn_w_in = (const float*)d_in[13]; const float* ffn_conv_w = (const float*)d_in[14]; const float* ffn_conv_b = (const float*)d_in[15];
    const float* ffn_w_out = (const float*)d_in[16]; const float* final_g = (const float*)d_in[17];
    float* out = (float*)d_out; char* ws = (char*)d_ws;
    float* mod = (float*)(ws + 0);
    bf16_t* XN = (bf16_t*)(ws + 1 * MiB);
    bf16_t* Q = (bf16_t*)(ws + 33 * MiB); bf16_t* Kb = (bf16_t*)(ws + 65 * MiB); bf16_t* V = (bf16_t*)(ws + 97 * MiB);
    bf16_t* G = (bf16_t*)(ws + 33 * MiB);
    float* a_f = (float*)(ws + 129 * MiB);
    bf16_t* CQ = (bf16_t*)(ws + 171 * MiB); bf16_t* CKV = (bf16_t*)(ws + 183 * MiB); bf16_t* Kr = (bf16_t*)(ws + 191 * MiB); bf16_t* Qr = (bf16_t*)(ws + 192 * MiB);
    float* lf = (float*)(ws + 208 * MiB); float* cumq = (float*)(ws + 209 * MiB); float* rope = (float*)(ws + 210 * MiB);
    const int GB = 2048;
    k_ada<<<(4 * 3072 + 255) / 256, 256, 0, stream>>>(c, ada_w, ada_b, mod);
    k_rope_table<<<(SEQ * 16 + 255) / 256, 256, 0, stream>>>(rope);
    const float C2F = 0.125f * LOG2E, C2M = 0.10206207261596577f * LOG2E;
    k_norm_mod<<<GB, 256, 0, stream>>>(x, mod + 0 * 6144, XN);
    k_gemm<EpiFoxIn><<<GB, 256, 0, stream>>>(XN, D, fox_w_in, 3088, 3088, 1024, EpiFoxIn{Q, Kb, V, lf, fox_b_f, C2F, 0});
    k_scan<<<BATCH * H, 256, 0, stream>>>(lf, cumq);
    k_attn<0, true><<<BATCH * H * 32, 256, 0, stream>>>(Q, nullptr, Kb, nullptr, V, cumq, Q);
    k_gemm<EpiResid><<<GB, 256, 0, stream>>>(Q, D, fox_w_o, 1024, 1024, 1024, EpiResid{x, out, mod + 0 * 6144});
    k_norm_mod<<<GB, 256, 0, stream>>>(out, mod + 1 * 6144, XN);
    k_ffn_up<<<GB, 256, 0, stream>>>(XN, ffn_w_in, ffn_conv_w, ffn_conv_b, G);
    k_gemm<EpiResid><<<GB, 256, 0, stream>>>(G, DFF, ffn_w_out, 1024, 1024, DFF, EpiResid{out, out, mod + 1 * 6144});
    k_norm_mod<<<GB, 256, 0, stream>>>(out, mod + 2 * 6144, XN);
    k_gemm<EpiMlaA><<<GB, 256, 0, stream>>>(XN, D, mla_w_a, 672, 672, 1024, EpiMlaA{a_f, Kr, rope});
    k_mla_prep<<<GB, 256, 0, stream>>>(a_f, mla_g_q, mla_g_kv, CQ, CKV);
    k_gemm<EpiMlaQ><<<GB, 256, 0, stream>>>(CQ, 384, mla_w_uq, 1536, 1536, 384, EpiMlaQ{Q, Qr, rope, C2M, 0});
    k_gemm<EpiMlaKV><<<GB, 256, 0, stream>>>(CKV, 256, mla_w_ukv, 2048, 2048, 256, EpiMlaKV{Kb, V});
    k_attn<32, false><<<BATCH * H * 32, 256, 0, stream>>>(Q, Qr, Kb, Kr, V, nullptr, Q);
    k_gemm<EpiResid><<<GB, 256, 0, stream>>>(Q, D, mla_w_o, 1024, 1024, 1024, EpiResid{out, out, mod + 2 * 6144});
    k_norm_mod<<<GB, 256, 0, stream>>>(out, mod + 3 * 6144, XN);
    k_ffn_up<<<GB, 256, 0, stream>>>(XN, ffn_w_in + (size_t)1024 * 5632, ffn_conv_w + 3 * 5632, ffn_conv_b + 5632, G);
    k_gemm<EpiResid><<<GB, 256, 0, stream>>>(G, DFF, ffn_w_out + (size_t)DFF * 1024, 1024, 1024, DFF, EpiResid{out, out, mod + 3 * 6144});
    k_final<<<GB, 256, 0, stream>>>(out, final_g);
}
```
